# Optimizing an MI355X kernel written in HIP

```python
import jax, jax.numpy as jnp
from jax import lax
import numpy as np

D_MODEL = 1024
BATCH = 4
SEQ = 4096
DEPTH = 1

N_META = 16
POOL_WIDTH = D_MODEL // 2
POOL_WINDOWS = (2, 4, 8, 16)
POOL_GROUP = POOL_WIDTH // len(POOL_WINDOWS)
N_HEADS = 8
HEAD_DIM = 64
ATTN_WIDTH = N_HEADS * HEAD_DIM
Q_BLOCK = 128
RMS_EPS = 1e-6
IN_SIZES = (POOL_WIDTH, POOL_WIDTH, ATTN_WIDTH, ATTN_WIDTH, ATTN_WIDTH, ATTN_WIDTH, N_HEADS, D_MODEL, D_MODEL)
N_IN = 2 * POOL_WIDTH + 4 * ATTN_WIDTH + N_HEADS + 2 * D_MODEL

kernel_name = "gated_pool_forgetting_attn_hybrid"


def _split_points():
    pts, acc = [], 0
    for s in IN_SIZES[:-1]:
        acc += s
        pts.append(acc)
    return pts


def rmsnorm(x, g):
    xf = x.astype(jnp.float32)
    xf = xf * lax.rsqrt(jnp.mean(xf * xf, axis=-1, keepdims=True) + RMS_EPS)
    return (xf * g.astype(jnp.float32)).astype(x.dtype)


def causal_multiscale_pool(u, pool_w, pool_scale):
    B, L, _ = u.shape
    groups = jnp.split(u, len(POOL_WINDOWS), axis=-1)
    pos = jnp.arange(L, dtype=jnp.float32)[:, None]
    pooled = []
    for w, ug in zip(POOL_WINDOWS, groups):
        uf = ug.astype(jnp.float32)
        c = jnp.cumsum(uf, axis=1)
        c_prev = jnp.pad(c, ((0, 0), (w, 0), (0, 0)))[:, :L]
        count = jnp.minimum(pos + 1.0, float(w))
        pooled.append((c - c_prev) / count - uf)
    p = jnp.stack(pooled, axis=2).astype(u.dtype)
    y = jnp.einsum('blgc,gcd->blgd', p, pool_w)
    return y.reshape(B, L, POOL_WIDTH) * pool_scale


def forgetting_attention(q, k, v, log_f):
    B, L, H, Dh = q.shape
    pad = (Q_BLOCK - L % Q_BLOCK) % Q_BLOCK
    padw = ((0, 0), (pad, 0), (0, 0), (0, 0))
    qp, kp, vp = jnp.pad(q, padw), jnp.pad(k, padw), jnp.pad(v, padw)
    c = jnp.cumsum(log_f, axis=1)
    c = jnp.transpose(jnp.pad(c, ((0, 0), (pad, 0), (0, 0))), (0, 2, 1))
    Lp = L + pad
    scale = 1.0 / np.sqrt(HEAD_DIM)
    outs = []
    for i in range(Lp // Q_BLOCK):
        q0, q1 = i * Q_BLOCK, (i + 1) * Q_BLOCK
        qb, kb, vb = qp[:, q0:q1], kp[:, :q1], vp[:, :q1]
        s = jnp.einsum('bqhd,bkhd->bhqk', qb, kb).astype(jnp.float32) * scale
        s = s + c[:, :, q0:q1, None] - c[:, :, None, :q1]
        q_idx = jnp.arange(q0, q1)[:, None]
        k_idx = jnp.arange(q1)[None, :]
        valid = (k_idx <= q_idx) & ((k_idx >= pad) | (k_idx == q_idx))
        s = jnp.where(valid, s, -jnp.inf)
        p = jax.nn.softmax(s, axis=-1)
        outs.append(jnp.einsum('bhqk,bkhd->bqhd', p.astype(vb.dtype), vb))
    o = jnp.concatenate(outs, axis=1)[:, pad:]
    return o


def hybrid_layer(x, norm_g, w_in, b_forget, pool_w, pool_scale, w_up_pool, w_up_attn, w_out):
    B, L, _ = x.shape
    h = rmsnorm(x, norm_g)
    proj = jnp.einsum('bld,dn->bln', h, w_in)
    u_pool, z_pool, q, k, v, z_attn, f_logit, g_pool, g_attn = jnp.split(proj, _split_points(), axis=-1)
    y_pool = causal_multiscale_pool(u_pool, pool_w, pool_scale) * jax.nn.silu(z_pool)
    q = q.reshape(B, L, N_HEADS, HEAD_DIM)
    k = k.reshape(B, L, N_HEADS, HEAD_DIM)
    v = v.reshape(B, L, N_HEADS, HEAD_DIM)
    log_f = jax.nn.log_sigmoid((f_logit + b_forget).astype(jnp.float32))
    y_attn = forgetting_attention(q, k, v, log_f).reshape(B, L, ATTN_WIDTH) * jax.nn.silu(z_attn)
    merged = (jax.nn.sigmoid(g_pool) * jnp.einsum('blc,cd->bld', y_pool, w_up_pool)
              + jax.nn.sigmoid(g_attn) * jnp.einsum('blc,cd->bld', y_attn, w_up_attn))
    return x + jnp.einsum('bld,de->ble', merged, w_out)


def setup_inputs(seed: int = 0) -> dict:
    key = jax.random.key(seed)
    ks = jax.random.split(key, 12)
    f0 = sum(IN_SIZES[:6])
    x = jax.random.normal(ks[0], (BATCH, SEQ, D_MODEL), jnp.float32)
    meta_tokens = jax.random.normal(ks[1], (N_META, D_MODEL), jnp.float32)
    norm_g = 1.0 + 0.02 * jax.random.normal(ks[2], (DEPTH, D_MODEL), jnp.float32)
    w_in = jax.random.normal(ks[3], (DEPTH, D_MODEL, N_IN), jnp.float32) * D_MODEL ** -0.5
    w_in = w_in.at[:, :, f0:f0 + N_HEADS].multiply(0.1)
    b_forget = (jnp.linspace(1.0, 6.0, N_HEADS, dtype=jnp.float32)[None, :]
                + 0.1 * jax.random.normal(ks[4], (DEPTH, N_HEADS), jnp.float32))
    pool_w = jax.random.normal(ks[5], (DEPTH, len(POOL_WINDOWS), POOL_GROUP, POOL_GROUP), jnp.float32) * POOL_GROUP ** -0.5
    pool_scale = 1.0 + 0.1 * jax.random.normal(ks[6], (DEPTH, POOL_WIDTH), jnp.float32)
    w_up_pool = jax.random.normal(ks[7], (DEPTH, POOL_WIDTH, D_MODEL), jnp.float32) * POOL_WIDTH ** -0.5
    w_up_attn = jax.random.normal(ks[8], (DEPTH, ATTN_WIDTH, D_MODEL), jnp.float32) * ATTN_WIDTH ** -0.5
    w_out = jax.random.normal(ks[9], (DEPTH, D_MODEL, D_MODEL), jnp.float32) * D_MODEL ** -0.5
    final_norm_g = 1.0 + 0.02 * jax.random.normal(ks[10], (D_MODEL,), jnp.float32)
    return {"x": x, "meta_tokens": meta_tokens, "norm_g": norm_g, "w_in": w_in,
            "b_forget": b_forget, "pool_w": pool_w, "pool_scale": pool_scale,
            "w_up_pool": w_up_pool, "w_up_attn": w_up_attn, "w_out": w_out,
            "final_norm_g": final_norm_g}


def reference(x, meta_tokens, norm_g, w_in, b_forget, pool_w, pool_scale, w_up_pool, w_up_attn, w_out, final_norm_g):
    B = x.shape[0]
    meta = jnp.broadcast_to(meta_tokens.astype(x.dtype)[None], (B, N_META, D_MODEL))
    h = jnp.concatenate([meta, x], axis=1)
    for l in range(DEPTH):
        h = hybrid_layer(h, norm_g[l], w_in[l], b_forget[l], pool_w[l], pool_scale[l],
                         w_up_pool[l], w_up_attn[l], w_out[l])
    h = rmsnorm(h, final_norm_g)
    return h[:, N_META:]
```

```cpp
#include <hip/hip_runtime.h>
#include <cstdint>
#include <cstdio>

constexpr int NB = 4, SEQ = 4096, NMETA = 16, LTOT = SEQ + NMETA, D = 1024, M = NB * SEQ;
constexpr int NH = 8, HD = 64, AW = 512, PW = 512;
constexpr int NIN = 5128, NPROJ = 5120, F0 = 3072;
constexpr int LP = 4224, ROW_META = 48, ROW_REAL = 128;
constexpr float RMS_EPS = 1e-6f;
constexpr float LOG2E = 1.4426950408889634f;
constexpr float C2 = 0.125f * LOG2E;

constexpr size_t MiB = 1u << 20;
constexpr size_t WS_CTL = 0, WS_WIN = 2 * MiB, WS_WUP = 12 * MiB, WS_WOUT = 14 * MiB, WS_PW = 16 * MiB, WS_HNM = 16 * MiB + 512 * 1024;
constexpr size_t WS_LOGF = 17 * MiB, WS_BIAS = 18 * MiB, WS_XCH = 19 * MiB;
constexpr size_t WS_XN = 20 * MiB, WS_MRG = 20 * MiB;
constexpr size_t WS_U = 52 * MiB, WS_ZP = 70 * MiB, WS_Q = 86 * MiB, WS_K = 104 * MiB, WS_V = 122 * MiB, WS_ZA = 140 * MiB;
constexpr size_t WS_SGP = 156 * MiB, WS_SGA = 188 * MiB, WS_Y = 220 * MiB, WS_END = 252 * MiB;
static_assert(WS_U + (size_t)NB * LTOT * PW * 2 <= WS_ZP && WS_ZP + (size_t)M * PW * 2 <= WS_Q && WS_Q + (size_t)NB * LP * AW * 2 <= WS_K && WS_K + (size_t)NB * LP * AW * 2 <= WS_V &&
              WS_V + (size_t)NB * LP * AW * 2 <= WS_ZA && WS_ZA + (size_t)M * AW * 2 <= WS_SGP && WS_SGP + (size_t)M * D * 2 <= WS_SGA && WS_SGA + (size_t)M * D * 2 <= WS_Y && WS_Y + (size_t)M * D * 2 <= WS_END &&
              WS_XN + (size_t)M * D * 2 <= WS_U && WS_WIN + (size_t)NPROJ * D * 2 <= WS_WUP && WS_LOGF + (size_t)NB * NH * LTOT * 4 <= WS_BIAS && WS_BIAS + (size_t)NB * NH * LP * 4 <= WS_XCH, "d_ws map");

typedef unsigned short bf16;
typedef short bf16x8 __attribute__((ext_vector_type(8)));
typedef float f32x16 __attribute__((ext_vector_type(16)));

__device__ __forceinline__ unsigned f2bf(float f) { unsigned u = __builtin_bit_cast(unsigned, f); return (u + 0x7fffu + ((u >> 16) & 1u)) >> 16; }
__device__ __forceinline__ float bf2f(bf16 b) { return __builtin_bit_cast(float, (unsigned)b << 16); }
__device__ __forceinline__ float sigmoidf_(float z) { return 1.0f / (1.0f + __expf(-z)); }
__device__ __forceinline__ float siluf_(float z) { return z / (1.0f + __expf(-z)); }
__device__ __forceinline__ float logsigmoidf_(float z) { return fminf(z, 0.f) - log1pf(__expf(-fabsf(z))); }
__device__ __forceinline__ float wave_sum(float v) {
#pragma unroll
    for (int o = 1; o < 64; o <<= 1) v += __shfl_xor(v, o);
    return v;
}

struct Ptrs {
    const float *x, *meta, *norm_g, *w_in, *b_forget, *pool_w, *pool_scale, *w_up_pool, *w_up_attn, *w_out, *final_g;
    float* out; unsigned char* ws;
};

__global__ void k_prep_weights(Ptrs P) {
    bf16* Win = (bf16*)(P.ws + WS_WIN); bf16* Wup = (bf16*)(P.ws + WS_WUP); bf16* Wout = (bf16*)(P.ws + WS_WOUT); bf16* PWt = (bf16*)(P.ws + WS_PW);
    const size_t n1 = (size_t)NPROJ * D, n2 = (size_t)D * D, n3 = (size_t)D * D, n4 = 4 * 128 * 128, tot = n1 + n2 + n3 + n4;
    for (size_t i = (size_t)blockIdx.x * blockDim.x + threadIdx.x; i < tot; i += (size_t)gridDim.x * blockDim.x) {
        if (i < n1) { const int n = (int)(i / D), k = (int)(i % D); const int sc = n < F0 ? n : n + 8; Win[i] = (bf16)f2bf(P.w_in[(size_t)k * NIN + sc]); }
        else if (i < n1 + n2) { const size_t j = i - n1; const int n = (int)(j / D), k = (int)(j % D); Wup[j] = (bf16)f2bf(k < 512 ? P.w_up_pool[(size_t)k * D + n] : P.w_up_attn[(size_t)(k - 512) * D + n]); }
        else if (i < n1 + n2 + n3) { const size_t j = i - n1 - n2; const int n = (int)(j / D), k = (int)(j % D); Wout[j] = (bf16)f2bf(P.w_out[(size_t)k * D + n]); }
        else { const size_t j = i - n1 - n2 - n3; const int g = (int)(j / 16384), d = (int)((j / 128) % 128), c = (int)(j % 128); PWt[j] = (bf16)f2bf(P.pool_w[(size_t)g * 16384 + c * 128 + d]); }
    }
}

__global__ void __launch_bounds__(256) k_rms_rows(Ptrs P) {
    __shared__ float red[4]; __shared__ float hn[D]; __shared__ float fl[4][8];
    const int row = blockIdx.x, tid = threadIdx.x, lane = tid & 63, wid = tid >> 6;
    const bool is_meta = row >= M;
    const float* xr = is_meta ? P.meta + (size_t)(row - M) * D : P.x + (size_t)row * D;
    float v[4], ss = 0.f;
#pragma unroll
    for (int j = 0; j < 4; ++j) { v[j] = xr[tid + 256 * j]; ss += v[j] * v[j]; }
    ss = wave_sum(ss); if (lane == 0) red[wid] = ss; __syncthreads();
    const float rstd = rsqrtf((red[0] + red[1] + red[2] + red[3]) * (1.0f / D) + RMS_EPS);
    float f[8] = {0, 0, 0, 0, 0, 0, 0, 0};
#pragma unroll
    for (int j = 0; j < 4; ++j) { const int c = tid + 256 * j; const float h = v[j] * rstd * P.norm_g[c]; hn[c] = h;
        const float* wf = P.w_in + (size_t)c * NIN + F0;
#pragma unroll
        for (int hh = 0; hh < 8; ++hh) f[hh] += h * wf[hh]; }
#pragma unroll
    for (int hh = 0; hh < 8; ++hh) { f[hh] = wave_sum(f[hh]); if (lane == 0) fl[wid][hh] = f[hh]; }
    __syncthreads();
    float* LOGF = (float*)(P.ws + WS_LOGF);
    if (!is_meta) {
        bf16* XN = (bf16*)(P.ws + WS_XN) + (size_t)row * D;
#pragma unroll
        for (int j = 0; j < 4; ++j) XN[tid + 256 * j] = (bf16)f2bf(hn[tid + 256 * j]);
        if (tid < 8) { const float z = fl[0][tid] + fl[1][tid] + fl[2][tid] + fl[3][tid] + P.b_forget[tid]; const int b = row / SEQ, t = row % SEQ;
            LOGF[((size_t)b * NH + tid) * LTOT + NMETA + t] = logsigmoidf_(z); }
    } else {
        float* HNM = (float*)(P.ws + WS_HNM) + (size_t)(row - M) * D;
#pragma unroll
        for (int j = 0; j < 4; ++j) HNM[tid + 256 * j] = hn[tid + 256 * j];
        if (tid < 8) { const float z = fl[0][tid] + fl[1][tid] + fl[2][tid] + fl[3][tid] + P.b_forget[tid];
            for (int b = 0; b < NB; ++b) LOGF[((size_t)b * NH + tid) * LTOT + (row - M)] = logsigmoidf_(z); }
    }
}
static_assert(F0 == 3072, "forget columns");

__global__ void k_meta_proj(Ptrs P) {
    const float* HNM = (const float*)(P.ws + WS_HNM);
    bf16* U = (bf16*)(P.ws + WS_U); bf16* Kb = (bf16*)(P.ws + WS_K); bf16* Vb = (bf16*)(P.ws + WS_V);
    const int idx = blockIdx.x * blockDim.x + threadIdx.x;
    if (idx < 16 * 1536) {
        const int r = idx / 1536, cc = idx % 1536, which = cc / 512, c = cc % 512;
        const int col = which == 0 ? c : (which == 1 ? 1536 + c : 2048 + c);
        float acc = 0.f;
        for (int k = 0; k < D; ++k) acc += HNM[r * D + k] * P.w_in[(size_t)k * NIN + col];
        const bf16 o = (bf16)f2bf(acc);
        for (int b = 0; b < NB; ++b) {
            if (which == 0) U[((size_t)b * LTOT + r) * PW + c] = o;
            else if (which == 1) Kb[((size_t)b * LP + ROW_META + r) * AW + c] = o;
            else Vb[((size_t)b * LP + ROW_META + r) * AW + c] = o;
        }
    }
    const int zi = idx;
    if (zi < NB * 112 * AW) { const int b = zi / (112 * AW), rr = (zi / AW) % 112, c = zi % AW; const int row = rr < 48 ? rr : rr + 16;
        Kb[((size_t)b * LP + row) * AW + c] = 0; Vb[((size_t)b * LP + row) * AW + c] = 0; }
}

template <class Epi, bool GATED> __global__ void __launch_bounds__(256) k_gemm_naive(const bf16* A, const bf16* Bt, int Mr, int Nc, int K, Epi E) {
    const int lane = threadIdx.x & 63, wid = threadIdx.x >> 6; const int r = lane & 31, h = lane >> 5;
    const int tiles_n = Nc / 32; const long tile = (long)blockIdx.x * 4 + wid; if (tile >= (long)(Mr / 32) * tiles_n) return;
    const int tm = (int)(tile / tiles_n), tn = (int)(tile % tiles_n);
    const bf16* ap = A + (size_t)(tm * 32 + r) * K + 8 * h; const bf16* bp = Bt + (size_t)(tn * 32 + r) * K + 8 * h;
    f32x16 acc1 = {}, acc2 = {};
    const int Kh = GATED ? K / 2 : K;
    for (int k = 0; k < Kh; k += 16) { const bf16x8 a = *(const bf16x8*)(ap + k), b = *(const bf16x8*)(bp + k); acc1 = __builtin_amdgcn_mfma_f32_32x32x16_bf16(a, b, acc1, 0, 0, 0); }
    if (GATED) for (int k = Kh; k < K; k += 16) { const bf16x8 a = *(const bf16x8*)(ap + k), b = *(const bf16x8*)(bp + k); acc2 = __builtin_amdgcn_mfma_f32_32x32x16_bf16(a, b, acc2, 0, 0, 0); }
#pragma unroll
    for (int i = 0; i < 16; ++i) { const int row = tm * 32 + (i & 3) + 8 * (i >> 2) + 4 * h, col = tn * 32 + r; E(row, col, acc1[i], acc2[i]); }
}

struct EpiProj {
    unsigned char* ws;
    __device__ __forceinline__ void operator()(int m, int n, float v, float) const {
        const int b = m / SEQ, t = m % SEQ, seg = n / 512, c = n % 512;
        if (seg == 0) ((bf16*)(ws + WS_U))[((size_t)b * LTOT + NMETA + t) * PW + c] = (bf16)f2bf(v);
        else if (seg == 1) ((bf16*)(ws + WS_ZP))[(size_t)m * PW + c] = (bf16)f2bf(siluf_(v));
        else if (seg == 2) ((bf16*)(ws + WS_Q))[((size_t)b * LP + ROW_REAL + t) * AW + c] = (bf16)f2bf(v * C2);
        else if (seg == 3) ((bf16*)(ws + WS_K))[((size_t)b * LP + ROW_REAL + t) * AW + c] = (bf16)f2bf(v);
        else if (seg == 4) ((bf16*)(ws + WS_V))[((size_t)b * LP + ROW_REAL + t) * AW + c] = (bf16)f2bf(v);
        else if (seg == 5) ((bf16*)(ws + WS_ZA))[(size_t)m * AW + c] = (bf16)f2bf(siluf_(v));
        else if (seg < 8) ((bf16*)(ws + WS_SGP))[(size_t)m * D + (n - 3072)] = (bf16)f2bf(sigmoidf_(v));
        else ((bf16*)(ws + WS_SGA))[(size_t)m * D + (n - 4096)] = (bf16)f2bf(sigmoidf_(v));
    }
};
struct EpiUp {
    unsigned char* ws;
    __device__ __forceinline__ void operator()(int m, int n, float vp, float va) const {
        const float gp = bf2f(((const bf16*)(ws + WS_SGP))[(size_t)m * D + n]), ga = bf2f(((const bf16*)(ws + WS_SGA))[(size_t)m * D + n]);
        ((bf16*)(ws + WS_MRG))[(size_t)m * D + n] = (bf16)f2bf(gp * vp + ga * va);
    }
};
struct EpiOut {
    const float* x; float* out;
    __device__ __forceinline__ void operator()(int m, int n, float v, float) const { out[(size_t)m * D + n] = x[(size_t)m * D + n] + v; }
};

__global__ void k_scan(Ptrs P) {
    const int bh = blockIdx.x * blockDim.x + threadIdx.x; if (bh >= NB * NH) return;
    const float* lf = (const float*)(P.ws + WS_LOGF) + (size_t)bh * LTOT; float* bias = (float*)(P.ws + WS_BIAS) + (size_t)bh * LP;
    for (int i = 0; i < ROW_META; ++i) bias[i] = -INFINITY;
    for (int i = ROW_META + NMETA; i < ROW_REAL; ++i) bias[i] = -INFINITY;
    float c = 0.f;
    for (int s = 0; s < LTOT; ++s) { c += lf[s]; bias[s < NMETA ? ROW_META + s : ROW_REAL + (s - NMETA)] = -c * LOG2E; }
}

__global__ void __launch_bounds__(256) k_attn_naive(Ptrs P) {
    const int lane = threadIdx.x & 63; const long w = (long)blockIdx.x * 4 + (threadIdx.x >> 6);
    if (w >= (long)NB * NH * SEQ) return;
    const int t = (int)(w % SEQ), h = (int)((w / SEQ) % NH), b = (int)(w / ((long)SEQ * NH));
    const bf16* Qb = (const bf16*)(P.ws + WS_Q); const bf16* Kb = (const bf16*)(P.ws + WS_K); const bf16* Vb = (const bf16*)(P.ws + WS_V);
    const float* bias = (const float*)(P.ws + WS_BIAS) + ((size_t)b * NH + h) * LP;
    const size_t rb = (size_t)b * LP; const int col = h * HD + lane;
    const float q = bf2f(Qb[(rb + ROW_REAL + t) * AW + col]);
    const float bref = bias[ROW_REAL + t];
    float m = -INFINITY, l = 0.f, o = 0.f;
    for (int part = 0; part < 2; ++part) {
        const int k0 = part == 0 ? ROW_META : ROW_REAL, k1 = part == 0 ? ROW_META + NMETA : ROW_REAL + t + 1;
        for (int kr = k0; kr < k1; ++kr) {
            const float s = wave_sum(q * bf2f(Kb[(rb + kr) * AW + col])) + (bias[kr] - bref);
            const float mn = fmaxf(m, s), alpha = exp2f(m - mn), p = exp2f(s - mn);
            l = l * alpha + p; o = o * alpha + p * bf2f(Vb[(rb + kr) * AW + col]); m = mn;
        }
    }
    const size_t mrow = (size_t)b * SEQ + t;
    const float za = bf2f(((const bf16*)(P.ws + WS_ZA))[mrow * AW + col]);
    ((bf16*)(P.ws + WS_Y))[mrow * D + 512 + col] = (bf16)f2bf(o / l * za);
}

__global__ void __launch_bounds__(512) k_pool_naive(Ptrs P) {
    __shared__ float p[PW];
    const int m = blockIdx.x, b = m / SEQ, t = m % SEQ, c = threadIdx.x;
    const bf16* U = (const bf16*)(P.ws + WS_U) + ((size_t)b * LTOT + NMETA + t) * PW;
    { const int g = c >> 7, w = 2 << g; float s = 0.f; for (int j = 0; j < w; ++j) s += bf2f(U[c - (long)j * PW]); p[c] = bf2f((bf16)f2bf(s / (float)w - bf2f(U[c]))); }
    __syncthreads();
    const int g = c >> 7, d = c & 127; const bf16* pw = (const bf16*)(P.ws + WS_PW) + ((size_t)g * 128 + d) * 128;
    float y = 0.f;
    for (int k = 0; k < 128; ++k) y += p[g * 128 + k] * bf2f(pw[k]);
    const float zp = bf2f(((const bf16*)(P.ws + WS_ZP))[(size_t)m * PW + c]);
    ((bf16*)(P.ws + WS_Y))[(size_t)m * D + c] = (bf16)f2bf(y * P.pool_scale[c] * zp);
}

__global__ void __launch_bounds__(256) k_final_norm(Ptrs P) {
    __shared__ float red[4];
    const int row = blockIdx.x, tid = threadIdx.x, lane = tid & 63, wid = tid >> 6;
    float* o = P.out + (size_t)row * D; float v[4], ss = 0.f;
#pragma unroll
    for (int j = 0; j < 4; ++j) { v[j] = o[tid + 256 * j]; ss += v[j] * v[j]; }
    ss = wave_sum(ss); if (lane == 0) red[wid] = ss; __syncthreads();
    const float rstd = rsqrtf((red[0] + red[1] + red[2] + red[3]) * (1.0f / D) + RMS_EPS);
#pragma unroll
    for (int j = 0; j < 4; ++j) o[tid + 256 * j] = v[j] * rstd * P.final_g[tid + 256 * j];
}

extern "C" void kernel_launch(void* const* d_in, const int* in_sizes, int n_in, void* d_out, int out_size, void* d_ws, size_t ws_size, hipStream_t stream) {
    if (n_in != 11 || out_size != M * D || ws_size < WS_END) { fprintf(stderr, "kernel_launch: unexpected shapes (n_in %d out %d ws %zu)\n", n_in, out_size, ws_size); return; }
    Ptrs P{};
    P.x = (const float*)d_in[0]; P.meta = (const float*)d_in[1]; P.norm_g = (const float*)d_in[2]; P.w_in = (const float*)d_in[3]; P.b_forget = (const float*)d_in[4];
    P.pool_w = (const float*)d_in[5]; P.pool_scale = (const float*)d_in[6]; P.w_up_pool = (const float*)d_in[7]; P.w_up_attn = (const float*)d_in[8]; P.w_out = (const float*)d_in[9];
    P.final_g = (const float*)d_in[10]; P.out = (float*)d_out; P.ws = (unsigned char*)d_ws;
    unsigned char* ws = P.ws;
    hipLaunchKernelGGL(k_prep_weights, dim3(2048), dim3(256), 0, stream, P);
    hipLaunchKernelGGL(k_rms_rows, dim3(M + NMETA), dim3(256), 0, stream, P);
    hipLaunchKernelGGL(k_meta_proj, dim3((NB * 112 * AW + 255) / 256), dim3(256), 0, stream, P);
    hipLaunchKernelGGL((k_gemm_naive<EpiProj, false>), dim3((M / 32) * (NPROJ / 32) / 4), dim3(256), 0, stream, (const bf16*)(ws + WS_XN), (const bf16*)(ws + WS_WIN), M, NPROJ, D, EpiProj{ws});
    hipLaunchKernelGGL(k_scan, dim3(1), dim3(64), 0, stream, P);
    hipLaunchKernelGGL(k_attn_naive, dim3(NB * NH * SEQ / 4), dim3(256), 0, stream, P);
    hipLaunchKernelGGL(k_pool_naive, dim3(M), dim3(512), 0, stream, P);
    hipLaunchKernelGGL((k_gemm_naive<EpiUp, true>), dim3((M / 32) * (D / 32) / 4), dim3(256), 0, stream, (const bf16*)(ws + WS_Y), (const bf16*)(ws + WS_WUP), M, D, D, EpiUp{ws});
    hipLaunchKernelGGL((k_gemm_naive<EpiOut, false>), dim3((M / 32) * (D / 32) / 4), dim3(256), 0, stream, (const bf16*)(ws + WS_MRG), (const bf16*)(ws + WS_WOUT), M, D, D, EpiOut{P.x, P.out});
    hipLaunchKernelGGL(k_final_norm, dim3(M), dim3(256), 0, stream, P);
}
```
